# Optimizing an MI355X kernel written in HIP

```python
import math
import jax, jax.numpy as jnp
from jax import lax
import numpy as np

D_MODEL = 1024
BATCH = 16
SEQ = 2048
DEPTH = 2

GRID_W = 64
CTX_LEN = 256
N_MIXERS = 2
N_HYENA = (DEPTH + 1) // 2
N_ATTN = DEPTH // 2
EPS = 1e-6

HY_STREAMS = 3
HY_SHORT = 3
HY_BANDS = 16
HY_EMB = 1 + 2 * HY_BANDS
HY_FILT_W = 64
HY_DECAY_TARGET = 1e-2
HY_FAST = 0.3
HY_SLOW = 1.5
HY_SHIFT = 0.0

HEAD_DIM = 128
N_HEADS = D_MODEL // HEAD_DIM
N_KV_HEADS = 2
GROUP = N_HEADS // N_KV_HEADS
QKV_DIM = (N_HEADS + 2 * N_KV_HEADS) * HEAD_DIM
ROPE_PAIRS = HEAD_DIM // 4
ROPE_THETA = 10000.0
Q_BLOCK = 128
ATTN_SCALE = HEAD_DIM ** -0.5

D_FF = 4 * D_MODEL

kernel_name = 'hyena_gqa_interleaved_dit_block'


def rms_norm(x, g):
    xf = x.astype(jnp.float32)
    y = xf * lax.rsqrt(jnp.mean(xf * xf, axis=-1, keepdims=True) + EPS)
    return (y * g).astype(x.dtype)


def modulation(cond, w, b):
    return jnp.split(jax.nn.silu(cond) @ w + b, 6, axis=-1)


def short_conv(z, w, b):
    L = z.shape[1]
    zp = jnp.pad(z, ((0, 0), (1, 1), (0, 0)))
    return zp[:, :L] * w[0] + zp[:, 1:L + 1] * w[1] + zp[:, 2:] * w[2] + b


def hyena_filters(L, w1, b1, f1, w2, b2, f2, w3):
    t = jnp.arange(L, dtype=jnp.float32) / L
    bands = jnp.linspace(1e-4, HY_BANDS - 1, HY_BANDS, dtype=jnp.float32)
    ang = 2.0 * math.pi * t[:, None] * bands[None, :]
    z = jnp.concatenate([t[:, None], jnp.cos(ang), jnp.sin(ang)], axis=-1)
    h = jnp.sin(f1 * (z @ w1 + b1))
    h = jnp.sin(f2 * (h @ w2 + b2))
    h = (h @ w3).astype(jnp.float32)
    deltas = jnp.abs(jnp.linspace(math.log(HY_DECAY_TARGET) / HY_SLOW,
                                  math.log(HY_DECAY_TARGET) / HY_FAST, D_MODEL, dtype=jnp.float32))
    decay = jnp.exp(-t[:, None] * deltas[None, :])
    h = h * (jnp.concatenate([decay, decay], axis=-1) + HY_SHIFT)
    return h[:, :D_MODEL], h[:, D_MODEL:]


def bidir_fftconv(u, h_f, h_b, bias):
    L = u.shape[1]
    k2 = jnp.concatenate([h_f, jnp.zeros((1, h_f.shape[1]), jnp.float32), h_b[:0:-1]], axis=0)
    kf = jnp.fft.rfft(k2, n=2 * L, axis=0)
    uf32 = u.astype(jnp.float32)
    uf = jnp.fft.rfft(uf32, n=2 * L, axis=1)
    y = jnp.fft.irfft(uf * kf[None], n=2 * L, axis=1)[:, :L]
    return (y + uf32 * bias).astype(u.dtype)


def hyena_mixer(h, w_in, b_in, conv_w, conv_b, fw1, fb1, ff1, fw2, fb2, ff2, fw3, fbias, w_out, b_out):
    L = h.shape[1]
    z = short_conv(h @ w_in + b_in, conv_w, conv_b)
    x1, x2, v = jnp.split(z, HY_STREAMS, axis=-1)
    h_f, h_b = hyena_filters(L, fw1, fb1, ff1, fw2, fb2, ff2, fw3)
    v = bidir_fftconv(v * x2, h_f, h_b, fbias)
    return (v * x1) @ w_out + b_out


def axial_rope_tables(rows):
    row = jnp.repeat(jnp.arange(rows, dtype=jnp.float32), GRID_W)
    col = jnp.tile(jnp.arange(GRID_W, dtype=jnp.float32), rows)
    inv = ROPE_THETA ** (-jnp.arange(ROPE_PAIRS, dtype=jnp.float32) / ROPE_PAIRS)
    ang = jnp.concatenate([row[:, None] * inv[None, :], col[:, None] * inv[None, :]], axis=-1)
    return jnp.cos(ang), jnp.sin(ang)


def apply_rope(x, cos, sin):
    xf = x.astype(jnp.float32).reshape(x.shape[:-1] + (HEAD_DIM // 2, 2))
    x0, x1 = xf[..., 0], xf[..., 1]
    out = jnp.stack([x0 * cos - x1 * sin, x0 * sin + x1 * cos], axis=-1)
    return out.reshape(x.shape).astype(x.dtype)


def project_qkv(h, w_qkv, q_gain, k_gain):
    B, L, _ = h.shape
    qkv = h @ w_qkv
    q = qkv[..., :N_HEADS * HEAD_DIM].reshape(B, L, N_KV_HEADS, GROUP, HEAD_DIM)
    k = qkv[..., N_HEADS * HEAD_DIM:(N_HEADS + N_KV_HEADS) * HEAD_DIM].reshape(B, L, N_KV_HEADS, HEAD_DIM)
    v = qkv[..., (N_HEADS + N_KV_HEADS) * HEAD_DIM:].reshape(B, L, N_KV_HEADS, HEAD_DIM)
    return rms_norm(q, q_gain), rms_norm(k, k_gain), v


def attend(q, k, v):
    s = jnp.einsum('bqkgd,bskd->bkgqs', q, k).astype(jnp.float32) * ATTN_SCALE
    p = jax.nn.softmax(s, axis=-1).astype(v.dtype)
    return jnp.einsum('bkgqs,bskd->bqkgd', p, v)


def gqa_mixer(h_lat, h_ctx, w_qkv, q_gain, k_gain, w_o, cos, sin, with_ctx_out):
    B, L, _ = h_lat.shape
    C = h_ctx.shape[1]
    q_l, k_l, v_l = project_qkv(h_lat, w_qkv, q_gain, k_gain)
    q_l = apply_rope(q_l, cos[:, None, None, :], sin[:, None, None, :])
    k_l = apply_rope(k_l, cos[:, None, :], sin[:, None, :])
    q_c, k_c, v_c = project_qkv(h_ctx, w_qkv, q_gain, k_gain)
    k_all = jnp.concatenate([k_l, k_c], axis=1)
    v_all = jnp.concatenate([v_l, v_c], axis=1)
    nb = L // Q_BLOCK
    q_blocks = jnp.moveaxis(q_l.reshape(B, nb, Q_BLOCK, N_KV_HEADS, GROUP, HEAD_DIM), 1, 0)
    o = lax.map(lambda qb: attend(qb, k_all, v_all), q_blocks)
    y_lat = jnp.moveaxis(o, 0, 1).reshape(B, L, N_HEADS * HEAD_DIM) @ w_o
    y_ctx = None
    if with_ctx_out:
        y_ctx = attend(q_c, k_c, v_c).reshape(B, C, N_HEADS * HEAD_DIM) @ w_o
    return y_lat, y_ctx


def sq_relu_mlp(h, w1, w2):
    return jnp.square(jax.nn.relu(h @ w1)) @ w2


def setup_inputs(seed: int = 0) -> dict:
    key = jax.random.key(seed)
    ks = iter(jax.random.split(key, 40))
    f32 = jnp.float32

    def nrm(shape, scale):
        return jax.random.normal(next(ks), shape, f32) * scale

    def gain(shape):
        return 1.0 + nrm(shape, 0.05)

    D = D_MODEL
    return {
        'x': nrm((BATCH, SEQ, D), 1.0),
        'c': nrm((BATCH, D), 1.0),
        'ctx': nrm((BATCH, CTX_LEN, D), 1.0),
        'c_ctx': nrm((D,), 1.0),
        'mod_w': nrm((DEPTH, D, 6 * D), 0.5 * D ** -0.5),
        'mod_b': nrm((DEPTH, 6 * D), 0.02),
        'mix_norm_pre': gain((DEPTH, D)),
        'mix_norm_post': gain((DEPTH, D)),
        'mlp_norm_pre': gain((DEPTH, D)),
        'mlp_norm_post': gain((DEPTH, D)),
        'mlp_w1': nrm((DEPTH, D, D_FF), D ** -0.5),
        'mlp_w2': nrm((DEPTH, D_FF, D), D_FF ** -0.5),
        'hy_w_in': nrm((N_HYENA, D, HY_STREAMS * D), D ** -0.5),
        'hy_b_in': nrm((N_HYENA, HY_STREAMS * D), 0.02),
        'hy_conv_w': nrm((N_HYENA, HY_SHORT, HY_STREAMS * D), HY_SHORT ** -0.5),
        'hy_conv_b': nrm((N_HYENA, HY_STREAMS * D), 0.02),
        'hy_filt_w1': nrm((N_HYENA, HY_EMB, HY_FILT_W), HY_EMB ** -0.5),
        'hy_filt_b1': nrm((N_HYENA, HY_FILT_W), 0.1),
        'hy_filt_freq1': gain((N_HYENA, HY_FILT_W)),
        'hy_filt_w2': nrm((N_HYENA, HY_FILT_W, HY_FILT_W), HY_FILT_W ** -0.5),
        'hy_filt_b2': nrm((N_HYENA, HY_FILT_W), 0.1),
        'hy_filt_freq2': gain((N_HYENA, HY_FILT_W)),
        'hy_filt_w3': nrm((N_HYENA, HY_FILT_W, 2 * D), HY_FILT_W ** -0.5),
        'hy_filt_bias': nrm((N_HYENA, D), 0.1),
        'hy_w_out': nrm((N_HYENA, D, D), D ** -0.5),
        'hy_b_out': nrm((N_HYENA, D), 0.02),
        'attn_w_qkv': nrm((N_ATTN, D, QKV_DIM), D ** -0.5),
        'attn_q_norm': gain((N_ATTN, HEAD_DIM)),
        'attn_k_norm': gain((N_ATTN, HEAD_DIM)),
        'attn_w_o': nrm((N_ATTN, N_HEADS * HEAD_DIM, D), D ** -0.5),
    }


def reference(x, c, ctx, c_ctx, mod_w, mod_b, mix_norm_pre, mix_norm_post, mlp_norm_pre, mlp_norm_post,
              mlp_w1, mlp_w2, hy_w_in, hy_b_in, hy_conv_w, hy_conv_b, hy_filt_w1, hy_filt_b1, hy_filt_freq1,
              hy_filt_w2, hy_filt_b2, hy_filt_freq2, hy_filt_w3, hy_filt_bias, hy_w_out, hy_b_out,
              attn_w_qkv, attn_q_norm, attn_k_norm, attn_w_o):
    L = x.shape[1]
    rows = L // GRID_W
    cos, sin = axial_rope_tables(rows)
    for i in range(DEPTH):
        last = i == DEPTH - 1
        j = i // N_MIXERS
        sh1, sc1, g1, sh2, sc2, g2 = [m[:, None, :] for m in modulation(c, mod_w[i], mod_b[i])]
        csh1, csc1, cg1, csh2, csc2, cg2 = modulation(c_ctx, mod_w[i], mod_b[i])

        hx = rms_norm(x, mix_norm_pre[i]) * (1.0 + sc1) + sh1
        hc = rms_norm(ctx, mix_norm_pre[i]) * (1.0 + csc1) + csh1
        if i % N_MIXERS == 0:
            hp = (hy_w_in[j], hy_b_in[j], hy_conv_w[j], hy_conv_b[j], hy_filt_w1[j], hy_filt_b1[j],
                  hy_filt_freq1[j], hy_filt_w2[j], hy_filt_b2[j], hy_filt_freq2[j], hy_filt_w3[j],
                  hy_filt_bias[j], hy_w_out[j], hy_b_out[j])
            yx = hyena_mixer(hx, *hp)
            yc = None if last else hyena_mixer(hc, *hp)
        else:
            yx, yc = gqa_mixer(hx, hc, attn_w_qkv[j], attn_q_norm[j], attn_k_norm[j], attn_w_o[j],
                               cos, sin, not last)
        x = x + g1 * rms_norm(yx, mix_norm_post[i])
        if not last:
            ctx = ctx + cg1 * rms_norm(yc, mix_norm_post[i])

        hx = rms_norm(x, mlp_norm_pre[i]) * (1.0 + sc2) + sh2
        x = x + g2 * rms_norm(sq_relu_mlp(hx, mlp_w1[i], mlp_w2[i]), mlp_norm_post[i])
        if not last:
            hc = rms_norm(ctx, mlp_norm_pre[i]) * (1.0 + csc2) + csh2
            ctx = ctx + cg2 * rms_norm(sq_relu_mlp(hc, mlp_w1[i], mlp_w2[i]), mlp_norm_post[i])
    return x
```

```cpp
#include <hip/hip_runtime.h>
#include <hip/hip_cooperative_groups.h>
#include <hip/hip_bf16.h>
#include <cstdio>
#include <cstdint>
namespace cg = cooperative_groups;

constexpr int DM = 1024, NB = 16, SEQ = 2048, CTXL = 256;
constexpr int TL = NB * SEQ;
constexpr int TC = NB * CTXL;
constexpr int TT = TL + TC;
constexpr int DFF = 4096, NQKV = 1536, HD = 128, NH = 8, NKVH = 2, SKV = SEQ + CTXL;
constexpr float EPS = 1e-6f;
constexpr int NWAVES = 8, NTHR = 512;
constexpr int LDS_BYTES = 147456;

constexpr size_t MiB = 1u << 20;
constexpr size_t WS_MOD = 1 * MiB;
constexpr size_t WS_H2 = 2 * MiB;
constexpr size_t WS_ROPE = 3 * MiB;
constexpr size_t WS_W = 4 * MiB;
constexpr size_t W_IN = WS_W, W_OUT = W_IN + 6 * MiB, W_1A = W_OUT + 2 * MiB, W_1B = W_1A + 8 * MiB, W_2A = W_1B + 8 * MiB, W_2B = W_2A + 8 * MiB,
                 W_QKV = W_2B + 8 * MiB, W_O = W_QKV + 3 * MiB, W_END = W_O + 2 * MiB;
constexpr size_t WS_XC = 49 * MiB;
constexpr size_t WS_R1 = 65 * MiB;
constexpr size_t WS_R2 = 209 * MiB;
constexpr size_t WS_END = 497 * MiB;
static_assert(W_END <= WS_XC, "ws map");
constexpr size_t WS_FL = WS_R1 + 72 * MiB;
constexpr size_t WS_FC = WS_FL + 16 * MiB;

typedef unsigned short bf16_t;
typedef short bf16x8 __attribute__((ext_vector_type(8)));
typedef float f32x4 __attribute__((ext_vector_type(4)));
typedef float f32x2 __attribute__((ext_vector_type(2)));
typedef unsigned u32x4 __attribute__((ext_vector_type(4)));
typedef unsigned u32x2 __attribute__((ext_vector_type(2)));
#define LAS __attribute__((address_space(3)))

__device__ __forceinline__ unsigned f2bf(float f) { unsigned u = __builtin_bit_cast(unsigned, f); return (u + 0x7fffu + ((u >> 16) & 1u)) >> 16; }
__device__ __forceinline__ unsigned pk2(float lo, float hi) { return f2bf(lo) | (f2bf(hi) << 16); }
__device__ __forceinline__ float bf2f(unsigned h) { return __builtin_bit_cast(float, h << 16); }
__device__ __forceinline__ float bflo(unsigned w) { return __builtin_bit_cast(float, w << 16); }
__device__ __forceinline__ float bfhi(unsigned w) { return __builtin_bit_cast(float, w & 0xffff0000u); }
__device__ __forceinline__ float wave_sum(float v) {
#pragma unroll
    for (int o = 1; o < 64; o <<= 1) v += __shfl_xor(v, o);
    return v;
}

namespace pg8 {
#define PG8_LAS __attribute__((address_space(3)))
constexpr int BM = 256, BK = 64, HALF = 128, HTB = HALF * BK * 2, STAGE_BYTES = 8 * HTB, NXCD = 8, WGM = 8;
__host__ __device__ __forceinline__ int lds_byte(int r, int c) { const int st = (r >> 4) * 2 + (c >> 5), rr = r & 15, cc = c & 31, ob = rr * 64 + cc * 2; return st * 1024 + (ob ^ (((ob >> 9) & 1) << 5)); }
__host__ __device__ __forceinline__ void stage_rc(int b, int& R, int& C) { const int st = b / 1024, sb = b % 1024, swz = sb ^ (((sb >> 9) & 1) << 5); R = (st >> 1) * 16 + swz / 64; C = (st & 1) * 32 + (swz % 64) / 2; }
__host__ __device__ __forceinline__ int perm32(int rho) { const int n = rho >> 4, i = rho & 15; return 8 * (i >> 2) + 4 * n + (i & 3); }
struct Unit { int pm, pn; };
struct Gemm { const bf16_t* A; const bf16_t* Bt; int M, N, K; };
struct StaticOrder {
    int nM, nN, nwg, G, c;
    __host__ __device__ void init(int M, int N, int G_, int c_) { nM = M / BM; nN = N / BM; nwg = nM * nN; G = G_; c = c_; }
    __host__ __device__ bool next(int i, Unit& u) const {
        const long L = (long)i * G + c; if (L >= nwg) return false;
        int wgid = (int)L; { const int q = nwg / NXCD, r = nwg % NXCD, xcd = wgid % NXCD, off = wgid / NXCD; wgid = (xcd < r ? xcd * (q + 1) : r * (q + 1) + (xcd - r) * q) + off; }
        const int nig = WGM * nN, gid = wgid / nig, fm = gid * WGM, gsz = (nM - fm) < WGM ? (nM - fm) : WGM;
        u.pm = fm + ((wgid % nig) % gsz); u.pn = (wgid % nig) / gsz; return true;
    }
    __device__ __forceinline__ void a_ready(const Unit&) const {}
    __device__ __forceinline__ void done(const Unit&) const {}
};
__device__ __forceinline__ unsigned cvt_pk_bf16(float lo, float hi) { unsigned r; asm volatile("v_cvt_pk_bf16_f32 %0, %1, %2" : "=v"(r) : "v"(lo), "v"(hi)); return r; }

template <class Epi, class Sched, bool ALIGN_EPI = false, bool SP2 = false>
__device__ __forceinline__ void gemm_phase(PG8_LAS unsigned char* lds, const Gemm g, const Sched& S, const Epi& E) {
    int tid_ = threadIdx.x; asm volatile("" : "+v"(tid_));
    const int tid = tid_, wid = __builtin_amdgcn_readfirstlane(tid >> 6), lane = tid & 63, wr = wid >> 2, wc = wid & 3, fr = lane & 15, fq = lane >> 4;
    const int K = g.K, nt = K / BK;
    unsigned voffA[2], voffB[2];
#pragma unroll
    for (int i = 0; i < 2; ++i) { int R, C; stage_rc(tid * 16 + i * 8192, R, C); const int Rb = Epi::PERM ? ((R & ~31) + perm32(R & 31)) : R;
        voffA[i] = (unsigned)(R * K + C) * 2u; voffB[i] = (unsigned)(Rb * K + C) * 2u; }
    const size_t kstep = (size_t)(BK * 2);
    const size_t hstep = (size_t)HALF * K * 2;
    const size_t tstep = 2 * hstep;
    const unsigned ldsw = (unsigned)wid * 1024u;
    const int aoff = lds_byte(wr * 64 + fr, fq * 8), boff = lds_byte(wc * 32 + fr, fq * 8);
#define PG8_SA(b, h) (((b) * 2 + (h)) * HTB)
#define PG8_SB(b, h) ((4 + (b) * 2 + (h)) * HTB)
#define PG8_STAGE(bufoff, gbase, voff) do { _Pragma("unroll") for (int _i = 0; _i < 2; ++_i) \
        __builtin_amdgcn_global_load_lds((const unsigned*)((const char*)(gbase) + (voff)[_i]), (PG8_LAS unsigned*)(lds + (bufoff) + ldsw + _i * 8192), 16, 0, 0); } while (0)
#define PG8_LDA(dst, b, h) do { _Pragma("unroll") for (int m = 0; m < 4; ++m) _Pragma("unroll") for (int k = 0; k < 2; ++k) dst[m][k] = *(const PG8_LAS bf16x8*)(lds + PG8_SA(b, h) + aoff + m * 2048 + k * 1024); } while (0)
#define PG8_LDB(dst, b, h) do { _Pragma("unroll") for (int n = 0; n < 2; ++n) _Pragma("unroll") for (int k = 0; k < 2; ++k) dst[n][k] = *(const PG8_LAS bf16x8*)(lds + PG8_SB(b, h) + boff + n * 2048 + k * 1024); } while (0)
#define PG8_MMA(ai, bj, At, Bt) do { __builtin_amdgcn_s_setprio(1); _Pragma("unroll") for (int m = 0; m < 4; ++m) _Pragma("unroll") for (int n = 0; n < 2; ++n) _Pragma("unroll") for (int k = 0; k < 2; ++k) \
        acc[ai][bj][m][n] = __builtin_amdgcn_mfma_f32_16x16x32_bf16(Bt[n][k], At[m][k], acc[ai][bj][m][n], 0, 0, 0); __builtin_amdgcn_s_setprio(0); } while (0)
#define PG8_WAIT_V(n) asm volatile("s_waitcnt vmcnt(" #n ")" ::: "memory")
#define PG8_WAIT_L(n) asm volatile("s_waitcnt lgkmcnt(" #n ")" ::: "memory")
#define PG8_BAR __builtin_amdgcn_s_barrier()
#define PG8_SCHED __builtin_amdgcn_sched_barrier(0)
    Unit cur, nxt; int ui = 0;
    if (!S.next(0, cur)) return;
    f32x4 acc[2][2][4][2];
#pragma unroll
    for (int a = 0; a < 2; ++a)
#pragma unroll
        for (int b = 0; b < 2; ++b)
#pragma unroll
            for (int m = 0; m < 4; ++m)
#pragma unroll
                for (int n = 0; n < 2; ++n) acc[a][b][m][n] = (f32x4){0.f, 0.f, 0.f, 0.f};
    bf16x8 At[4][2], B0[2][2], B1[2][2];
    const char* cA = (const char*)g.A + (size_t)cur.pm * tstep; const char* cB = (const char*)g.Bt + (size_t)cur.pn * tstep;
    S.a_ready(cur);
    if constexpr (SP2) {
        PG8_STAGE(PG8_SB(0, 0), cB, voffB); PG8_STAGE(PG8_SB(0, 1), cB + hstep, voffB); PG8_STAGE(PG8_SA(0, 0), cA, voffA); PG8_STAGE(PG8_SA(0, 1), cA + hstep, voffA);
        if (wr == 1) PG8_BAR;
        PG8_WAIT_V(2); PG8_BAR;
        PG8_STAGE(PG8_SB(1, 0), cB + kstep, voffB); PG8_STAGE(PG8_SA(1, 0), cA + kstep, voffA); PG8_STAGE(PG8_SB(1, 1), cB + hstep + kstep, voffB);
        PG8_WAIT_V(6); PG8_BAR;
    } else {
        PG8_STAGE(PG8_SB(0, 0), cB, voffB); PG8_STAGE(PG8_SA(0, 0), cA, voffA); PG8_STAGE(PG8_SB(0, 1), cB + hstep, voffB); PG8_STAGE(PG8_SA(0, 1), cA + hstep, voffA);
        if (wr == 1) PG8_BAR;
        PG8_WAIT_V(4); PG8_BAR;
        PG8_STAGE(PG8_SB(1, 0), cB + kstep, voffB); PG8_STAGE(PG8_SA(1, 0), cA + kstep, voffA); PG8_STAGE(PG8_SB(1, 1), cB + hstep + kstep, voffB);
        PG8_WAIT_V(6); PG8_BAR;
    }
    for (;;) {
        const bool has_next = S.next(ui + 1, nxt);
        const char* nA = has_next ? (const char*)g.A + (size_t)nxt.pm * tstep : cA; const char* nB = has_next ? (const char*)g.Bt + (size_t)nxt.pn * tstep : cB;
        for (int t = 0; t < nt; t += 2) {
            const bool last = (t == nt - 2);
            const char* a1 = cA + (size_t)(t + 1) * kstep;
            const char* a2 = last ? nA : cA + (size_t)(t + 2) * kstep; const char* b2 = last ? nB : cB + (size_t)(t + 2) * kstep;
            const char* a3 = a2 + kstep; const char* b3 = b2 + kstep;
            if (last && has_next) S.a_ready(nxt);
            if constexpr (SP2) {
            PG8_LDB(B0, 0, 0); PG8_LDB(B1, 0, 1); PG8_SCHED; PG8_LDA(At, 0, 0); PG8_STAGE(PG8_SA(1, 1), a1 + hstep, voffA);
            PG8_WAIT_V(8); PG8_WAIT_L(0); PG8_BAR; PG8_MMA(0, 0, At, B0); PG8_MMA(0, 1, At, B1); PG8_BAR; PG8_SCHED;
            PG8_LDA(At, 0, 1); PG8_STAGE(PG8_SB(0, 0), b2, voffB); PG8_STAGE(PG8_SB(0, 1), b2 + hstep, voffB); PG8_STAGE(PG8_SA(0, 0), a2, voffA);
            PG8_WAIT_V(8); PG8_WAIT_L(0); PG8_BAR; PG8_MMA(1, 0, At, B0); PG8_MMA(1, 1, At, B1); PG8_BAR; PG8_SCHED;
            PG8_LDB(B0, 1, 0); PG8_LDB(B1, 1, 1); PG8_SCHED; PG8_LDA(At, 1, 0); PG8_STAGE(PG8_SA(0, 1), a2 + hstep, voffA);
            PG8_WAIT_V(8); PG8_WAIT_L(0); PG8_BAR; PG8_MMA(0, 0, At, B0); PG8_MMA(0, 1, At, B1); PG8_BAR; PG8_SCHED;
            PG8_LDA(At, 1, 1); PG8_STAGE(PG8_SB(1, 0), b3, voffB); PG8_STAGE(PG8_SB(1, 1), b3 + hstep, voffB); PG8_STAGE(PG8_SA(1, 0), a3, voffA);
            PG8_WAIT_V(8); PG8_WAIT_L(0); PG8_BAR; PG8_MMA(1, 0, At, B0); PG8_MMA(1, 1, At, B1); PG8_BAR; PG8_SCHED;
            } else {
            PG8_LDB(B0, 0, 0); PG8_SCHED; PG8_LDA(At, 0, 0); PG8_STAGE(PG8_SA(1, 1), a1 + hstep, voffA);
            PG8_WAIT_L(8); PG8_BAR; PG8_WAIT_L(0); PG8_MMA(0, 0, At, B0); PG8_BAR; PG8_SCHED;
            PG8_LDB(B1, 0, 1); PG8_STAGE(PG8_SB(0, 0), b2, voffB);
            PG8_BAR; PG8_WAIT_L(0); PG8_MMA(0, 1, At, B1); PG8_BAR;
            PG8_LDA(At, 0, 1); PG8_STAGE(PG8_SA(0, 0), a2, voffA);
            PG8_BAR; PG8_WAIT_L(0); PG8_MMA(1, 0, At, B0); PG8_BAR; PG8_SCHED;
            PG8_STAGE(PG8_SB(0, 1), b2 + hstep, voffB);
            PG8_WAIT_V(6); PG8_BAR; PG8_MMA(1, 1, At, B1); PG8_BAR;
            PG8_LDB(B0, 1, 0); PG8_SCHED; PG8_LDA(At, 1, 0); PG8_STAGE(PG8_SA(0, 1), a2 + hstep, voffA);
            PG8_WAIT_L(8); PG8_BAR; PG8_WAIT_L(0); PG8_MMA(0, 0, At, B0); PG8_BAR; PG8_SCHED;
            PG8_LDB(B1, 1, 1); PG8_STAGE(PG8_SB(1, 0), b3, voffB);
            PG8_BAR; PG8_WAIT_L(0); PG8_MMA(0, 1, At, B1); PG8_BAR;
            PG8_LDA(At, 1, 1); PG8_STAGE(PG8_SA(1, 0), a3, voffA);
            PG8_BAR; PG8_WAIT_L(0); PG8_MMA(1, 0, At, B0); PG8_BAR; PG8_SCHED;
            PG8_STAGE(PG8_SB(1, 1), b3 + hstep, voffB);
            PG8_WAIT_V(6); PG8_BAR; PG8_MMA(1, 1, At, B1); PG8_BAR;
            }
        }
        if constexpr (ALIGN_EPI) { if (wr == 0) PG8_BAR; }
        if constexpr (!Epi::AFTER_DRAIN) { E(acc, cur, wr, wc, fr, fq); S.done(cur); }
        if (!has_next) break;
#pragma unroll
        for (int a = 0; a < 2; ++a)
#pragma unroll
            for (int b = 0; b < 2; ++b)
#pragma unroll
                for (int m = 0; m < 4; ++m)
#pragma unroll
                    for (int n = 0; n < 2; ++n) acc[a][b][m][n] = (f32x4){0.f, 0.f, 0.f, 0.f};
        cur = nxt; cA = nA; cB = nB; ++ui;
        if constexpr (ALIGN_EPI) { if (wr == 1) PG8_BAR; }
    }
    PG8_WAIT_V(0);
    if constexpr (!ALIGN_EPI) { if (wr == 0) PG8_BAR; }
    PG8_BAR;
    if constexpr (Epi::AFTER_DRAIN) { E.fused(acc, cur, wr, wc, fr, fq, lds, wid, lane); S.done(cur); }
#undef PG8_SA
#undef PG8_SB
#undef PG8_STAGE
#undef PG8_LDA
#undef PG8_LDB
#undef PG8_MMA
#undef PG8_WAIT_V
#undef PG8_WAIT_L
#undef PG8_BAR
#undef PG8_SCHED
}

template <int ACT, int BIASMODE> struct EpiBf16 {
    static constexpr bool PERM = true, AFTER_DRAIN = false;
    bf16_t* O; int ldc; const float* bias;
    __device__ __forceinline__ void operator()(const f32x4 (&acc)[2][2][4][2], const Unit& u, int wr, int wc, int fr, int fq) const {
        const int row0 = u.pm * BM + wr * 64 + fr; const int col0 = u.pn * BM + wc * 32 + 8 * fq;
        f32x4 bv[2][2];
#pragma unroll
        for (int bj = 0; bj < 2; ++bj)
#pragma unroll
            for (int n = 0; n < 2; ++n) bv[bj][n] = (BIASMODE == 1) ? *(const f32x4*)(bias + col0 + bj * HALF + 4 * n) : (f32x4){0.f, 0.f, 0.f, 0.f};
#pragma unroll
        for (int ai = 0; ai < 2; ++ai)
#pragma unroll
            for (int m = 0; m < 4; ++m) { const int row = row0 + ai * HALF + m * 16; bf16_t* rowp = O + (size_t)row * ldc + col0;
                const float rb = (BIASMODE == 2) ? bias[row] : 0.f;
#pragma unroll
                for (int bj = 0; bj < 2; ++bj) { f32x4 v0 = acc[ai][bj][m][0] + bv[bj][0] + rb, v1 = acc[ai][bj][m][1] + bv[bj][1] + rb;
                    if (ACT == 1) {
#pragma unroll
                        for (int e = 0; e < 4; ++e) { const float a0 = fmaxf(v0[e], 0.f), a1 = fmaxf(v1[e], 0.f); v0[e] = a0 * a0; v1[e] = a1 * a1; } }
                    u32x4 w; w.x = cvt_pk_bf16(v0[0], v0[1]); w.y = cvt_pk_bf16(v0[2], v0[3]); w.z = cvt_pk_bf16(v1[0], v1[1]); w.w = cvt_pk_bf16(v1[2], v1[3]);
                    *(u32x4*)(rowp + bj * HALF) = w; } }
    }
};
struct EpiF32 {
    static constexpr bool PERM = false, AFTER_DRAIN = false;
    float* O; int ldc; const float* bias;
    __device__ __forceinline__ void operator()(const f32x4 (&acc)[2][2][4][2], const Unit& u, int wr, int wc, int fr, int fq) const {
        const int row0 = u.pm * BM + wr * 64 + fr; const int col0 = u.pn * BM + wc * 32 + 4 * fq;
        f32x4 bv[2][2];
#pragma unroll
        for (int bj = 0; bj < 2; ++bj)
#pragma unroll
            for (int n = 0; n < 2; ++n) bv[bj][n] = bias ? *(const f32x4*)(bias + col0 + bj * HALF + n * 16) : (f32x4){0.f, 0.f, 0.f, 0.f};
#pragma unroll
        for (int ai = 0; ai < 2; ++ai)
#pragma unroll
            for (int m = 0; m < 4; ++m) { float* rowp = O + (size_t)(row0 + ai * HALF + m * 16) * ldc + col0;
#pragma unroll
                for (int bj = 0; bj < 2; ++bj)
#pragma unroll
                    for (int n = 0; n < 2; ++n) *(f32x4*)(rowp + bj * HALF + n * 16) = acc[ai][bj][m][n] + bv[bj][n]; }
    }
};
struct EpiQKV {
    static constexpr bool PERM = true, AFTER_DRAIN = false;
    bf16_t* Q; bf16_t* Kall; bf16_t* Vall; int nq; int seqlen; int koff;
    __device__ __forceinline__ void operator()(const f32x4 (&acc)[2][2][4][2], const Unit& u, int wr, int wc, int fr, int fq) const {
        const int row0 = u.pm * BM + wr * 64 + fr; const int cl = wc * 32 + 8 * fq;
#pragma unroll
        for (int ai = 0; ai < 2; ++ai)
#pragma unroll
            for (int m = 0; m < 4; ++m) { const int row = row0 + ai * HALF + m * 16; bf16_t* rowp;
                if (u.pn < nq) rowp = Q + (size_t)row * 1024 + u.pn * BM + cl;
                else { const int b = row / seqlen, s = row - b * seqlen; rowp = (u.pn == nq ? Kall : Vall) + ((size_t)b * SKV + koff + s) * 256 + cl; }
#pragma unroll
                for (int bj = 0; bj < 2; ++bj) { const f32x4 v0 = acc[ai][bj][m][0], v1 = acc[ai][bj][m][1];
                    u32x4 w; w.x = cvt_pk_bf16(v0[0], v0[1]); w.y = cvt_pk_bf16(v0[2], v0[3]); w.z = cvt_pk_bf16(v1[0], v1[1]); w.w = cvt_pk_bf16(v1[2], v1[3]);
                    *(u32x4*)(rowp + bj * HALF) = w; } }
    }
};
}

namespace attn {
using bf16 = __hip_bfloat16;
constexpr int D = 128, NW = 8, QBLK = 32, KVBLK = 64;
constexpr float SCALE = 0.088388347648318440f;
constexpr float THR = 8.f;
constexpr int LDQ = 1024, LDK = 256, LDO = 1024;
constexpr size_t SHM_V = KVBLK * D * 2, SHM_K = KVBLK * D * 2, SHM_ATTN = 2 * SHM_V + 2 * SHM_K + NW * 64 * 4;
using s16x4 = __attribute__((ext_vector_type(4))) short;
using f32x16 = __attribute__((ext_vector_type(16))) float;
#define KSWZ(row, colB) ((row) * 256 + ((colB) ^ (((row) & 7) << 4)))
#define SBAR() __builtin_amdgcn_sched_barrier(0)
__device__ __forceinline__ int crow(int r, int hi) { return (r & 3) + 8 * (r >> 2) + 4 * hi; }
__device__ __forceinline__ unsigned cvtpk(float lo, float hi) { unsigned r; asm volatile("v_cvt_pk_bf16_f32 %0, %1, %2" : "=v"(r) : "v"(lo), "v"(hi)); return r; }
__device__ __forceinline__ void partialSM(f32x16& p0, f32x16& p1, float& m_reg, float& mn, float& alpha) {
  constexpr float C = SCALE * 1.4426950408889634f;
  float pmax = p0[0]; for (int r = 1; r < 16; ++r) pmax = fmaxf(pmax, p0[r]); for (int r = 0; r < 16; ++r) pmax = fmaxf(pmax, p1[r]);
  { auto rr = __builtin_amdgcn_permlane32_swap(__float_as_uint(pmax), __float_as_uint(pmax), false, false);
    pmax = fmaxf(__uint_as_float(rr[0]), __uint_as_float(rr[1])); }
  if (__builtin_expect(__all(pmax - m_reg <= THR / SCALE), 1)) { mn = m_reg; alpha = 1.f; }
  else { mn = fmaxf(m_reg, pmax); alpha = __builtin_amdgcn_exp2f((m_reg - mn) * C); m_reg = mn; }
  float mnC = -mn * C;
  for (int r = 0; r < 16; ++r) p0[r] = fmaf(p0[r], C, mnC); for (int r = 0; r < 16; ++r) p1[r] = fmaf(p1[r], C, mnC);
  for (int r = 0; r < 16; ++r) p0[r] = __builtin_amdgcn_exp2f(p0[r]);
}
__device__ __forceinline__ void finishSM(f32x16& p0, f32x16& p1, float alpha, float& l_reg, bf16x8& pa0, bf16x8& pa1, bf16x8& pa2, bf16x8& pa3) {
  for (int r = 0; r < 16; ++r) p1[r] = __builtin_amdgcn_exp2f(p1[r]);
  float ps = 0; for (int r = 0; r < 16; ++r) ps += p0[r]; for (int r = 0; r < 16; ++r) ps += p1[r];
  { auto rr = __builtin_amdgcn_permlane32_swap(__float_as_uint(ps), __float_as_uint(ps), false, false);
    ps = __uint_as_float(rr[0]) + __uint_as_float(rr[1]); }
  l_reg = l_reg * alpha + ps;
#define PK4(P, BASE, OUT) do { unsigned a0 = cvtpk(P[BASE + 0], P[BASE + 1]), a1 = cvtpk(P[BASE + 2], P[BASE + 3]);   \
    unsigned b0 = cvtpk(P[BASE + 4], P[BASE + 5]), b1 = cvtpk(P[BASE + 6], P[BASE + 7]);                              \
    auto r0 = __builtin_amdgcn_permlane32_swap(a0, b0, false, false); auto r1 = __builtin_amdgcn_permlane32_swap(a1, b1, false, false); \
    u32x4 w = {r0[0], r1[0], r0[1], r1[1]}; OUT = *reinterpret_cast<bf16x8*>(&w); } while (0)
  PK4(p0, 0, pa0); PK4(p0, 8, pa1); PK4(p1, 0, pa2); PK4(p1, 8, pa3);
#undef PK4
}
__device__ __forceinline__ void qkt(f32x16& p0, f32x16& p1, const bf16* Ks, const bf16x8* qr, int r32, int hi) {
  p0 = f32x16{}; p1 = f32x16{};
  for (int d0 = 0; d0 < 8; ++d0) { int cb = (d0 * 16 + hi * 8) * 2;
    bf16x8 b0 = *reinterpret_cast<const bf16x8*>((const char*)Ks + KSWZ(r32, cb));
    bf16x8 b1 = *reinterpret_cast<const bf16x8*>((const char*)Ks + KSWZ(32 + r32, cb));
    p0 = __builtin_amdgcn_mfma_f32_32x32x16_bf16(b0, qr[d0], p0, 0, 0, 0);
    p1 = __builtin_amdgcn_mfma_f32_32x32x16_bf16(b1, qr[d0], p1, 0, 0, 0); }
}
__device__ __forceinline__ int v_st(int k, int c) { const int kk = (k & ~0xC) | ((k & 4) << 1) | ((k & 8) >> 1); return ((kk >> 3) * 4 + (c >> 5)) * 512 + ((kk & 7) * 32 + (c & 31)) * 2; }
__device__ __forceinline__ int v_rd_base(int lane) { return ((lane & 3) << 3) | (((lane >> 2) & 3) << 6) | (((lane >> 4) & 1) << 5) | (((lane >> 5) & 1) << 8); }
constexpr int v_rd_off(int d0, int ks, int half) { return d0 * 512 + ks * 4096 + half * 2048; }
template <int OFF> __device__ __forceinline__ s16x4 tr_read(int vb) {
  s16x4 r; asm volatile("ds_read_b64_tr_b16 %0, %1 offset:%2" : "=&v"(r) : "v"(vb), "i"(OFF) : "memory"); return r;
}
template <int D0> __device__ __forceinline__ void pv_one(f32x16& od, int vb, bf16x8 pa0, bf16x8 pa1, bf16x8 pa2, bf16x8 pa3) {
  const s16x4 l0 = tr_read<v_rd_off(D0, 0, 0)>(vb), h0 = tr_read<v_rd_off(D0, 0, 1)>(vb), l1 = tr_read<v_rd_off(D0, 1, 0)>(vb), h1 = tr_read<v_rd_off(D0, 1, 1)>(vb);
  const s16x4 l2 = tr_read<v_rd_off(D0, 2, 0)>(vb), h2 = tr_read<v_rd_off(D0, 2, 1)>(vb), l3 = tr_read<v_rd_off(D0, 3, 0)>(vb), h3 = tr_read<v_rd_off(D0, 3, 1)>(vb);
  asm volatile("s_waitcnt lgkmcnt(0)" ::: "memory"); SBAR();
#define PK(L, H) (bf16x8){L[0], L[1], L[2], L[3], H[0], H[1], H[2], H[3]}
  od = __builtin_amdgcn_mfma_f32_32x32x16_bf16(pa0, PK(l0, h0), od, 0, 0, 0);
  od = __builtin_amdgcn_mfma_f32_32x32x16_bf16(pa1, PK(l1, h1), od, 0, 0, 0);
  od = __builtin_amdgcn_mfma_f32_32x32x16_bf16(pa2, PK(l2, h2), od, 0, 0, 0);
  od = __builtin_amdgcn_mfma_f32_32x32x16_bf16(pa3, PK(l3, h3), od, 0, 0, 0);
#undef PK
}
__device__ __forceinline__ void pv_d0(f32x16* o, int vb, bf16x8 pa0, bf16x8 pa1, bf16x8 pa2, bf16x8 pa3) {
  pv_one<0>(o[0], vb, pa0, pa1, pa2, pa3); pv_one<1>(o[1], vb, pa0, pa1, pa2, pa3); pv_one<2>(o[2], vb, pa0, pa1, pa2, pa3); pv_one<3>(o[3], vb, pa0, pa1, pa2, pa3);
}
__device__ __forceinline__ void attn_dense_body(const bf16* __restrict__ Qb, const bf16* __restrict__ Kh, const bf16* __restrict__ Vh,
                                                bf16* __restrict__ Ob, int seq, char* lds) {
  int tid_ = threadIdx.x; asm volatile("" : "+v"(tid_));
  const int tid = tid_, wid = tid >> 6, lane = tid & 63, r32 = lane & 31, hi = lane >> 5;
  bf16* V_lds = (bf16*)lds; bf16* K_lds = (bf16*)(lds + 2 * SHM_V);
  float* ws = (float*)(lds + 2 * SHM_V + 2 * SHM_K) + wid * 64; float* li_l = ws; float* al_l = ws + 32;
  float m_reg = -1e30f, l_reg = 0; f32x16 o[4] = {}; bf16x8 qr[8];
  const bf16* Qw = Qb + (long)(wid * QBLK + r32) * LDQ + hi * 8;
#pragma unroll
  for (int d0 = 0; d0 < 8; ++d0) qr[d0] = *reinterpret_cast<const bf16x8*>(Qw + d0 * 16);
  const int sr = tid >> 4, sc = (tid & 15) * 8, vst0 = v_st(sr, sc), vst1 = v_st(32 + sr, sc);
  const int vb0 = (int)(uintptr_t)V_lds + v_rd_base(lane);
  struct { bf16x8 vs0, vs1, ks0, ks1; } sr_[2];
#define SLOAD(i, k0) do { sr_[i].vs0 = *reinterpret_cast<const bf16x8*>(&Vh[(long)((k0) + sr) * LDK + sc]); sr_[i].vs1 = *reinterpret_cast<const bf16x8*>(&Vh[(long)((k0) + 32 + sr) * LDK + sc]); \
    sr_[i].ks0 = *reinterpret_cast<const bf16x8*>(&Kh[(long)((k0) + sr) * LDK + sc]); sr_[i].ks1 = *reinterpret_cast<const bf16x8*>(&Kh[(long)((k0) + 32 + sr) * LDK + sc]); } while (0)
#define SWRITE(b, i) do { *(bf16x8*)((char*)V_lds + (b) * SHM_V + vst0) = sr_[i].vs0;          \
    *(bf16x8*)((char*)V_lds + (b) * SHM_V + vst1) = sr_[i].vs1; int kc = sc * 2;               \
    *(bf16x8*)((char*)K_lds + (b) * SHM_K + KSWZ(sr, kc)) = sr_[i].ks0;                       \
    *(bf16x8*)((char*)K_lds + (b) * SHM_K + KSWZ(32 + sr, kc)) = sr_[i].ks1; } while (0)
#define SWAIT() do { asm volatile("s_waitcnt vmcnt(4)" ::: "memory"); } while (0)
#define RESC(a) do { if (__any((a) < 1.f)) { if (hi == 0) al_l[r32] = (a); asm volatile("s_waitcnt lgkmcnt(0)" ::: "memory"); \
    for (int d = 0; d < 4; ++d) for (int r = 0; r < 16; ++r) o[d][r] *= al_l[crow(r, hi)]; } } while (0)
  f32x16 pA0, pA1, pB0, pB1; float mnA, mnB, alA, alB; bf16x8 pa0, pa1, pa2, pa3; const int NT = seq / KVBLK;
  constexpr int SE = 0, SO = 1;
  SLOAD(SE, 0); asm volatile("s_waitcnt vmcnt(0)" ::: "memory"); SWRITE(0, SE); __syncthreads();
  qkt(pA0, pA1, K_lds, qr, r32, hi); partialSM(pA0, pA1, m_reg, mnA, alA);
  SLOAD(SO, KVBLK); if (2 < NT) SLOAD(SE, 2 * KVBLK);
  SWAIT(); SWRITE(1, SO); __syncthreads();
  for (int j = 1; j + 1 < NT; j += 2) {
    SBAR(); qkt(pB0, pB1, (bf16*)((char*)K_lds + SHM_K), qr, r32, hi);
    finishSM(pA0, pA1, alA, l_reg, pa0, pa1, pa2, pa3); SBAR();
    SLOAD(SO, (j + 2) * KVBLK); SBAR();
    pv_d0(o, vb0, pa0, pa1, pa2, pa3); partialSM(pB0, pB1, m_reg, mnB, alB);
    __syncthreads(); SWAIT(); SWRITE(0, SE);
    RESC(alB); __syncthreads();
    SBAR(); qkt(pA0, pA1, K_lds, qr, r32, hi);
    finishSM(pB0, pB1, alB, l_reg, pa0, pa1, pa2, pa3); SBAR();
    if (j + 3 < NT) SLOAD(SE, (j + 3) * KVBLK); SBAR();
    pv_d0(o, vb0 + (int)SHM_V, pa0, pa1, pa2, pa3); partialSM(pA0, pA1, m_reg, mnA, alA);
    __syncthreads(); SWAIT(); SWRITE(1, SO);
    RESC(alA); __syncthreads();
  }
  SBAR(); qkt(pB0, pB1, (bf16*)((char*)K_lds + SHM_K), qr, r32, hi);
  finishSM(pA0, pA1, alA, l_reg, pa0, pa1, pa2, pa3); SBAR();
  pv_d0(o, vb0, pa0, pa1, pa2, pa3); partialSM(pB0, pB1, m_reg, mnB, alB);
  __syncthreads(); RESC(alB);
  finishSM(pB0, pB1, alB, l_reg, pa0, pa1, pa2, pa3); SBAR();
  pv_d0(o, vb0 + (int)SHM_V, pa0, pa1, pa2, pa3);
  if (hi == 0) li_l[r32] = l_reg; asm volatile("s_waitcnt lgkmcnt(0)" ::: "memory");
  float rli[16];
#pragma unroll
  for (int r = 0; r < 16; ++r) rli[r] = __builtin_amdgcn_rcpf(li_l[crow(r, hi)]);
  unsigned short* Ow = (unsigned short*)Ob + (long)(wid * QBLK) * LDO;
#pragma unroll
  for (int r = 0; r < 16; ++r) { int orow = crow(r, hi);
    for (int d0 = 0; d0 < 4; ++d0) Ow[(long)orow * LDO + d0 * 32 + r32] = (unsigned short)f2bf(o[d0][r] * rli[r]); }
#undef SLOAD
#undef SWRITE
#undef SWAIT
#undef RESC
}
#undef KSWZ
#undef SBAR
}

struct Args { const float* in[30]; float* out; unsigned char* ws; };
enum { I_X = 0, I_C, I_CTX, I_CCTX, I_MODW, I_MODB, I_MIXPRE, I_MIXPOST, I_MLPPRE, I_MLPPOST, I_W1, I_W2, I_HWIN, I_HBIN, I_HCW, I_HCB, I_FW1, I_FB1, I_FF1, I_FW2, I_FB2, I_FF2,
       I_FW3, I_FBIAS, I_HWOUT, I_HBOUT, I_WQKV, I_QN, I_KN, I_WO };

__device__ __forceinline__ void transpose_item(const float* W, int K, int N, bf16_t* WT, LAS float* scr, int item, int lane) {
    const int nblk = N / 32, kb = item / nblk, nb = item % nblk, k0 = 64 * kb, n0 = 32 * nb;
#pragma unroll 8
    for (int i = 0; i < 32; ++i) { const int kk = 2 * i + (lane >> 5); scr[kk * 33 + (lane & 31)] = W[(size_t)(k0 + kk) * N + n0 + (lane & 31)]; }
    asm volatile("s_waitcnt lgkmcnt(0)" ::: "memory");
    const int c = lane & 7;
#pragma unroll
    for (int j = 0; j < 4; ++j) { const int n = (lane >> 3) + 8 * j; const LAS float* s = scr + (8 * c) * 33 + n;
        u32x4 o; o.x = pk2(s[0 * 33], s[1 * 33]); o.y = pk2(s[2 * 33], s[3 * 33]); o.z = pk2(s[4 * 33], s[5 * 33]); o.w = pk2(s[6 * 33], s[7 * 33]);
        *(u32x4*)(WT + (size_t)(n0 + n) * K + k0 + 8 * c) = o; }
    asm volatile("s_waitcnt lgkmcnt(0)" ::: "memory");
}

__device__ __forceinline__ const float* modp(const float* mod, int l, int r, int which) { return mod + ((size_t)(l * 17 + r) * 6 + which) * 1024; }

__device__ __forceinline__ void row_norm_mod(const float* xrow, const float* gain, const float* sc, const float* sh, bf16_t* orow, int lane) {
    f32x4 v[4]; float ss = 0.f;
#pragma unroll
    for (int j = 0; j < 4; ++j) { v[j] = *(const f32x4*)(xrow + 4 * lane + 256 * j); ss += (v[j].x * v[j].x + v[j].y * v[j].y) + (v[j].z * v[j].z + v[j].w * v[j].w); }
    const float rstd = 1.0f / sqrtf(wave_sum(ss) * (1.f / DM) + EPS);
#pragma unroll
    for (int j = 0; j < 4; ++j) { const int c = 4 * lane + 256 * j; const f32x4 g = *(const f32x4*)(gain + c), s1 = *(const f32x4*)(sc + c), s0 = *(const f32x4*)(sh + c);
        const f32x4 o = v[j] * rstd * g * (s1 + 1.0f) + s0;
        u32x2 w; w.x = pk2(o.x, o.y); w.y = pk2(o.z, o.w); *(u32x2*)(orow + c) = w; }
}
__device__ __forceinline__ void row_update(const float* yrow, const float* xin, float* xout, const float* gate, const float* post,
                                           bf16_t* xn, const float* pre, const float* sc, const float* sh, int lane) {
    f32x4 y[4], x[4]; float ss = 0.f;
#pragma unroll
    for (int j = 0; j < 4; ++j) { y[j] = *(const f32x4*)(yrow + 4 * lane + 256 * j); x[j] = *(const f32x4*)(xin + 4 * lane + 256 * j);
        ss += (y[j].x * y[j].x + y[j].y * y[j].y) + (y[j].z * y[j].z + y[j].w * y[j].w); }
    const float rstd = 1.0f / sqrtf(wave_sum(ss) * (1.f / DM) + EPS);
    float s2 = 0.f;
#pragma unroll
    for (int j = 0; j < 4; ++j) { const int c = 4 * lane + 256 * j; const f32x4 g = *(const f32x4*)(gate + c), p = *(const f32x4*)(post + c);
        x[j] = x[j] + g * (y[j] * rstd * p); *(f32x4*)(xout + c) = x[j];
        s2 += (x[j].x * x[j].x + x[j].y * x[j].y) + (x[j].z * x[j].z + x[j].w * x[j].w); }
    if (xn) {
        const float r2 = 1.0f / sqrtf(wave_sum(s2) * (1.f / DM) + EPS);
#pragma unroll
        for (int j = 0; j < 4; ++j) { const int c = 4 * lane + 256 * j; const f32x4 g = *(const f32x4*)(pre + c), s1 = *(const f32x4*)(sc + c), s0 = *(const f32x4*)(sh + c);
            const f32x4 o = x[j] * r2 * g * (s1 + 1.0f) + s0;
            u32x2 w; w.x = pk2(o.x, o.y); w.y = pk2(o.z, o.w); *(u32x2*)(xn + c) = w; }
    }
}

template <int L, int US>
__device__ __forceinline__ void conv_wave(const LAS unsigned char* Ub, const LAS unsigned char* Fa, const LAS unsigned char* Fb, int tb0, f32x4 (&acc)[16], int lane) {
    const int i = lane & 15, q = lane >> 4;
    const int mb = (L - 1) - i + 8 * q;
    const LAS unsigned char* fbase = (i & 1) ? (Fa + 2 * mb) : (Fb + 2 * (mb - 1));
    const LAS unsigned char* ub = Ub + i * US + q * 16;
    bf16x8 W[16];
#define LDFRAG(dst, f) do { const LAS unsigned* p_ = (const LAS unsigned*)(fbase - 32 * (f)); u32x4 w_; w_.x = p_[0]; w_.y = p_[1]; w_.z = p_[2]; w_.w = p_[3]; dst = __builtin_bit_cast(bf16x8, w_); } while (0)
#pragma unroll
    for (int j = 0; j < 16; ++j) LDFRAG(W[j], tb0 + j);
    bf16x8 un = *(const LAS bf16x8*)(ub);
    constexpr int NSB = L / 32;
    for (int it = 0; it < NSB / 8; ++it) {
#pragma unroll
        for (int k = 0; k < 8; ++k) {
            const int sb = it * 8 + k; const int F = tb0 - 2 * sb;
            const bf16x8 uf = un;
            acc[14] = __builtin_amdgcn_mfma_f32_16x16x32_bf16(W[(14 - 2 * k) & 15], uf, acc[14], 0, 0, 0);
            acc[15] = __builtin_amdgcn_mfma_f32_16x16x32_bf16(W[(15 - 2 * k) & 15], uf, acc[15], 0, 0, 0);
            if (sb + 1 < NSB) { LDFRAG(W[(14 - 2 * k) & 15], F - 2); LDFRAG(W[(15 - 2 * k) & 15], F - 1); un = *(const LAS bf16x8*)(ub + 64 * (sb + 1)); }
#pragma unroll
            for (int j = 0; j < 14; ++j) acc[j] = __builtin_amdgcn_mfma_f32_16x16x32_bf16(W[(j - 2 * k) & 15], uf, acc[j], 0, 0, 0);
        }
    }
#undef LDFRAG
}

struct SC3 { float w0, w1, w2, b; };
__device__ __forceinline__ SC3 sc3_load(const float* cw, const float* cb, int ch) { SC3 s; s.w0 = cw[ch]; s.w1 = cw[3072 + ch]; s.w2 = cw[2 * 3072 + ch]; s.b = cb[ch]; return s; }

__device__ __forceinline__ u32x4 build_u8(const bf16_t* zv, const bf16_t* zx, int s8, int L, const SC3& cv, const SC3& cx) {
    const u32x4 mv = *(const u32x4*)(zv + s8), mx = *(const u32x4*)(zx + s8);
    float v[10], x[10];
    v[0] = s8 > 0 ? bf2f(zv[s8 - 1]) : 0.f; x[0] = s8 > 0 ? bf2f(zx[s8 - 1]) : 0.f;
    v[9] = s8 + 8 < L ? bf2f(zv[s8 + 8]) : 0.f; x[9] = s8 + 8 < L ? bf2f(zx[s8 + 8]) : 0.f;
    v[1] = bflo(mv.x); v[2] = bfhi(mv.x); v[3] = bflo(mv.y); v[4] = bfhi(mv.y); v[5] = bflo(mv.z); v[6] = bfhi(mv.z); v[7] = bflo(mv.w); v[8] = bfhi(mv.w);
    x[1] = bflo(mx.x); x[2] = bfhi(mx.x); x[3] = bflo(mx.y); x[4] = bfhi(mx.y); x[5] = bflo(mx.z); x[6] = bfhi(mx.z); x[7] = bflo(mx.w); x[8] = bfhi(mx.w);
    float u[8];
#pragma unroll
    for (int e = 0; e < 8; ++e) { const float a = v[e] * cv.w0 + v[e + 1] * cv.w1 + v[e + 2] * cv.w2 + cv.b; const float b = x[e] * cx.w0 + x[e + 1] * cx.w1 + x[e + 2] * cx.w2 + cx.b; u[e] = a * b; }
    u32x4 o; o.x = pk2(u[0], u[1]); o.y = pk2(u[2], u[3]); o.z = pk2(u[4], u[5]); o.w = pk2(u[6], u[7]); return o;
}
__device__ __forceinline__ void conv_store(const f32x4 (&acc)[16], const bf16_t* z1, bf16_t* outp, int tb0, int L, const SC3& c1, int lane) {
    const int q = lane >> 4;
#pragma unroll
    for (int j = 0; j < 16; ++j) { const int t4 = 16 * (tb0 + j) + 4 * q;
        const u32x2 m = *(const u32x2*)(z1 + t4); float z[6];
        z[0] = t4 > 0 ? bf2f(z1[t4 - 1]) : 0.f; z[5] = t4 + 4 < L ? bf2f(z1[t4 + 4]) : 0.f;
        z[1] = bflo(m.x); z[2] = bfhi(m.x); z[3] = bflo(m.y); z[4] = bfhi(m.y);
        float o[4];
#pragma unroll
        for (int e = 0; e < 4; ++e) o[e] = acc[j][e] * (z[e] * c1.w0 + z[e + 1] * c1.w1 + z[e + 2] * c1.w2 + c1.b);
        u32x2 w; w.x = pk2(o[0], o[1]); w.y = pk2(o[2], o[3]); *(u32x2*)(outp + t4) = w; }
}

__global__ void __launch_bounds__(NTHR, 2) fwd_kernel(Args a) {
    extern __shared__ __attribute__((aligned(16))) unsigned char lds[];
    cg::grid_group grid = cg::this_grid();
    LAS unsigned char* L3 = (LAS unsigned char*)lds;
    const int tid = threadIdx.x, lane = tid & 63, wave = __builtin_amdgcn_readfirstlane(tid >> 6);
    const int G = gridDim.x, bid = blockIdx.x;
    const int gw = bid * NWAVES + wave, NGW = G * NWAVES;
    unsigned char* ws = a.ws;
    float* MOD = (float*)(ws + WS_MOD); float* H2 = (float*)(ws + WS_H2); float* ROPEC = (float*)(ws + WS_ROPE); float* ROPES = ROPEC + 2048 * 64;
    bf16_t* Win_t = (bf16_t*)(ws + W_IN); bf16_t* Wout_t = (bf16_t*)(ws + W_OUT); bf16_t* W1_t[2] = {(bf16_t*)(ws + W_1A), (bf16_t*)(ws + W_1B)};
    bf16_t* W2_t[2] = {(bf16_t*)(ws + W_2A), (bf16_t*)(ws + W_2B)}; bf16_t* Wqkv_t = (bf16_t*)(ws + W_QKV); bf16_t* Wo_t = (bf16_t*)(ws + W_O);
    float* XC = (float*)(ws + WS_XC);
    unsigned char* R1 = ws + WS_R1; unsigned char* R2 = ws + WS_R2;
    bf16_t* FL = (bf16_t*)(ws + WS_FL); bf16_t* FC = (bf16_t*)(ws + WS_FC);

    {
        LAS float* scr = (LAS float*)(L3 + wave * 16384);
        constexpr int I_IN = (DM / 64) * (3072 / 32), I_SQ = (DM / 64) * (DM / 32), I_UP = (DM / 64) * (DFF / 32), I_DN = (DFF / 64) * (DM / 32), I_QK = (DM / 64) * (NQKV / 32);
        constexpr int NITEMS = I_IN + I_SQ + 2 * I_UP + 2 * I_DN + I_QK + I_SQ;
        for (int it = gw; it < NITEMS; it += NGW) {
            int r = it;
            if (r < I_IN) { transpose_item(a.in[I_HWIN], DM, 3072, Win_t, scr, r, lane); continue; } r -= I_IN;
            if (r < I_SQ) { transpose_item(a.in[I_HWOUT], DM, DM, Wout_t, scr, r, lane); continue; } r -= I_SQ;
            if (r < I_UP) { transpose_item(a.in[I_W1], DM, DFF, W1_t[0], scr, r, lane); continue; } r -= I_UP;
            if (r < I_UP) { transpose_item(a.in[I_W1] + (size_t)DM * DFF, DM, DFF, W1_t[1], scr, r, lane); continue; } r -= I_UP;
            if (r < I_DN) { transpose_item(a.in[I_W2], DFF, DM, W2_t[0], scr, r, lane); continue; } r -= I_DN;
            if (r < I_DN) { transpose_item(a.in[I_W2] + (size_t)DFF * DM, DFF, DM, W2_t[1], scr, r, lane); continue; } r -= I_DN;
            if (r < I_QK) { transpose_item(a.in[I_WQKV], DM, NQKV, Wqkv_t, scr, r, lane); continue; } r -= I_QK;
            transpose_item(a.in[I_WO], DM, DM, Wo_t, scr, r, lane);
        }
        __syncthreads();
        for (int task = bid; task < 192; task += G) {
            const int l = task / 96, n0 = (task % 96) * 64, k0 = wave * 128;
            LAS float* sl = (LAS float*)(L3) + wave * (17 * 128);
            LAS float* red = (LAS float*)(L3 + 8 * 17 * 128 * 4);
            for (int r = 0; r < 17; ++r)
                for (int kk = lane; kk < 128; kk += 64) { const float v = (r < 16) ? a.in[I_C][r * DM + k0 + kk] : a.in[I_CCTX][k0 + kk]; sl[r * 128 + kk] = v / (1.f + __expf(-v)); }
            __syncthreads();
            float acc[17];
#pragma unroll
            for (int r = 0; r < 17; ++r) acc[r] = 0.f;
            const float* Wm = a.in[I_MODW] + (size_t)l * DM * 6144 + (size_t)k0 * 6144 + n0 + lane;
#pragma unroll 4
            for (int kk = 0; kk < 128; ++kk) { const float w = Wm[(size_t)kk * 6144];
#pragma unroll
                for (int r = 0; r < 17; ++r) acc[r] += sl[r * 128 + kk] * w; }
#pragma unroll
            for (int r = 0; r < 17; ++r) red[(wave * 17 + r) * 64 + lane] = acc[r];
            __syncthreads();
            for (int o = tid; o < 17 * 64; o += NTHR) { const int r = o >> 6, n = o & 63; float s = 0.f;
#pragma unroll
                for (int w = 0; w < 8; ++w) s += red[(w * 17 + r) * 64 + n];
                MOD[(size_t)(l * 17 + r) * 6144 + n0 + n] = s + a.in[I_MODB][l * 6144 + n0 + n]; }
            __syncthreads();
        }
        for (int ti = gw; ti < SEQ + CTXL; ti += NGW) {
            const int cls = ti >= SEQ, t = cls ? ti - SEQ : ti; const float tt = (float)t / (float)(cls ? CTXL : SEQ);
            float zk = 0.f;
            if (lane == 0) zk = tt;
            else if (lane <= 32) { const int kb = (lane - 1) & 15; const float band = 1e-4f + (float)kb * ((15.0f - 1e-4f) / 15.0f); const float ang = 6.283185307179586f * tt * band; zk = lane <= 16 ? cosf(ang) : sinf(ang); }
            float a1 = a.in[I_FB1][lane];
            for (int k = 0; k < 33; ++k) a1 += __shfl(zk, k) * a.in[I_FW1][k * 64 + lane];
            const float h1 = sinf(a.in[I_FF1][lane] * a1);
            float a2 = a.in[I_FB2][lane];
            for (int k = 0; k < 64; ++k) a2 += __shfl(h1, k) * a.in[I_FW2][k * 64 + lane];
            H2[(size_t)ti * 64 + lane] = sinf(a.in[I_FF2][lane] * a2);
        }
        for (int idx = bid * NTHR + tid; idx < SEQ * 64; idx += G * NTHR) {
            const int t = idx >> 6, i = idx & 63, p = i & 31; const float inv = exp2f(-(float)p * (13.287712379549449f / 32.0f));
            const float pos = (float)(i < 32 ? (t >> 6) : (t & 63)); const float ang = pos * inv;
            ROPEC[idx] = cosf(ang); ROPES[idx] = sinf(ang);
        }
    }
    grid.sync();

    bf16_t* XN1 = (bf16_t*)R1;
    {
        for (int m = gw; m < TT; m += NGW) {
            const float* xr = m < TL ? a.in[I_X] + (size_t)m * DM : a.in[I_CTX] + (size_t)(m - TL) * DM; const int r = m < TL ? m / SEQ : 16;
            row_norm_mod(xr, a.in[I_MIXPRE], modp(MOD, 0, r, 1), modp(MOD, 0, r, 0), XN1 + (size_t)m * DM, lane);
        }
        const float lo = -3.0701134573253945f, hi = -15.350567286626973f;
        for (int idx = bid * NTHR + tid; idx < (SEQ + CTXL) * DM; idx += G * NTHR) {
            int cls, c, t, Lc;
            if (idx < SEQ * DM) { cls = 0; c = idx / SEQ; t = idx % SEQ; Lc = SEQ; } else { const int j = idx - SEQ * DM; cls = 1; c = j / CTXL; t = j % CTXL; Lc = CTXL; }
            const float* h2 = H2 + (size_t)(cls ? SEQ + t : t) * 64; const float* w3 = a.in[I_FW3];
            float hf = 0.f, hb = 0.f;
#pragma unroll 8
            for (int k = 0; k < 64; ++k) { const float h = h2[k]; hf += h * w3[k * 2048 + c]; hb += h * w3[k * 2048 + 1024 + c]; }
            const float delta = -(lo + (hi - lo) * ((float)c / 1023.0f));
            const float dec = expf(-((float)t / (float)Lc) * delta);
            hf *= dec; hb *= dec;
            if (t == 0) hf += a.in[I_FBIAS][c];
            bf16_t* Ra = cls ? FC + (size_t)c * 2 * 512 : FL + (size_t)c * 2 * 4096; bf16_t* Rb = Ra + 2 * Lc;
            const int C0 = Lc - 1; const bf16_t vf = (bf16_t)f2bf(hf), vb = (bf16_t)f2bf(hb);
            Ra[C0 - t] = vf; if (C0 - t - 1 >= 0) Rb[C0 - t - 1] = vf;
            if (t >= 1) { Ra[C0 + t] = vb; Rb[C0 + t - 1] = vb; }
        }
    }
    grid.sync();

    bf16_t* ZT = (bf16_t*)R2;
    {
        pg8::Gemm g{Win_t, XN1, 3072, TT, DM}; pg8::StaticOrder S; S.init(3072, TT, G, bid);
        pg8::EpiBf16<0, 2> E{ZT, TT, a.in[I_HBIN]};
        pg8::gemm_phase<pg8::EpiBf16<0, 2>, pg8::StaticOrder, true, true>(L3, g, S, E);
    }
    grid.sync();

    bf16_t* GT = (bf16_t*)(R2 + 216 * MiB);
    {
        constexpr int USL = (SEQ + 8) * 2, USC = (CTXL + 8) * 2;
        constexpr int OFF_F = 69632;
        const float* cw = a.in[I_HCW]; const float* cb = a.in[I_HCB];
        for (int c = bid; c < DM; c += G) {
            const bf16_t* zx1 = ZT + (size_t)c * TT; const bf16_t* zx2 = ZT + (size_t)(1024 + c) * TT; const bf16_t* zv = ZT + (size_t)(2048 + c) * TT;
            const SC3 cv = sc3_load(cw, cb, 2048 + c), cx = sc3_load(cw, cb, 1024 + c), c1 = sc3_load(cw, cb, c);
            for (int qd = tid; qd < 16 * 256; qd += NTHR) { const int b = qd >> 8, s8 = (qd & 255) * 8;
                const u32x4 u = build_u8(zv + b * SEQ, zx2 + b * SEQ, s8, SEQ, cv, cx);
                *(LAS u32x4*)(L3 + b * USL + s8 * 2) = u; }
            { const u32x4* src = (const u32x4*)(FL + (size_t)c * 2 * 4096);
              for (int qd = tid; qd < 1024; qd += NTHR) { const int cp = qd >> 9, o = qd & 511; *(LAS u32x4*)(L3 + OFF_F + cp * (8192 + 64) + o * 16) = src[qd]; } }
            __syncthreads();
            f32x4 acc[16];
#pragma unroll
            for (int j = 0; j < 16; ++j) acc[j] = (f32x4){0.f, 0.f, 0.f, 0.f};
            conv_wave<SEQ, USL>(L3, L3 + OFF_F, L3 + OFF_F + 8192 + 64, 16 * wave, acc, lane);
            const int b = lane & 15;
            conv_store(acc, zx1 + b * SEQ, GT + (size_t)c * TT + b * SEQ, 16 * wave, SEQ, c1, lane);
            __syncthreads();
        }
        for (int task = bid; task < DM / 8; task += G) {
            const int c = task * 8 + wave;
            const bf16_t* zx1 = ZT + (size_t)c * TT + TL; const bf16_t* zx2 = ZT + (size_t)(1024 + c) * TT + TL; const bf16_t* zv = ZT + (size_t)(2048 + c) * TT + TL;
            const SC3 cv = sc3_load(cw, cb, 2048 + c), cx = sc3_load(cw, cb, 1024 + c), c1 = sc3_load(cw, cb, c);
            LAS unsigned char* Uw = L3 + wave * (16 * USC); LAS unsigned char* Fw = L3 + OFF_F + wave * 2176;
            for (int qd = lane; qd < 16 * 32; qd += 64) { const int b = qd >> 5, s8 = (qd & 31) * 8;
                const u32x4 u = build_u8(zv + b * CTXL, zx2 + b * CTXL, s8, CTXL, cv, cx);
                *(LAS u32x4*)(Uw + b * USC + s8 * 2) = u; }
            { const u32x4* src = (const u32x4*)(FC + (size_t)c * 2 * 512);
              for (int qd = lane; qd < 128; qd += 64) { const int cp = qd >> 6, o = qd & 63; *(LAS u32x4*)(Fw + cp * (1024 + 64) + o * 16) = src[qd]; } }
            __syncthreads();
            f32x4 acc[16];
#pragma unroll
            for (int j = 0; j < 16; ++j) acc[j] = (f32x4){0.f, 0.f, 0.f, 0.f};
            conv_wave<CTXL, USC>(Uw, Fw, Fw + 1024 + 64, 0, acc, lane);
            const int b = lane & 15;
            conv_store(acc, zx1 + b * CTXL, GT + (size_t)c * TT + TL + b * CTXL, 0, CTXL, c1, lane);
            __syncthreads();
        }
    }
    grid.sync();

    bf16_t* Gm = (bf16_t*)R1;
    {
        LAS bf16_t* tile = (LAS bf16_t*)L3;
        for (int item = bid; item < 16 * (TT / 64); item += G) {
            const int c0 = (item & 15) * 64, t0 = (item >> 4) * 64;
            { const int cr = tid >> 3, tch = tid & 7; const u32x4 v = *(const u32x4*)(GT + (size_t)(c0 + cr) * TT + t0 + 8 * tch);
              const unsigned wv[4] = {v.x, v.y, v.z, v.w};
#pragma unroll
              for (int e = 0; e < 8; ++e) tile[(8 * tch + e) * 72 + cr] = (bf16_t)((wv[e >> 1] >> ((e & 1) * 16)) & 0xffffu); }
            __syncthreads();
            { const int tr = tid >> 3, cch = tid & 7; const u32x4 v = *(const LAS u32x4*)(tile + tr * 72 + 8 * cch);
              *(u32x4*)(Gm + (size_t)(t0 + tr) * DM + c0 + 8 * cch) = v; }
            __syncthreads();
        }
    }
    grid.sync();

    float* Y2 = (float*)R2;
    {
        pg8::Gemm g{Gm, Wout_t, TT, DM, DM}; pg8::StaticOrder S; S.init(TT, DM, G, bid);
        pg8::EpiF32 E{Y2, DM, a.in[I_HBOUT]};
        pg8::gemm_phase<pg8::EpiF32, pg8::StaticOrder, true, true>(L3, g, S, E);
    }
    grid.sync();

    {
        for (int m = gw; m < TT; m += NGW) {
            const bool lat = m < TL; const int r = lat ? m / SEQ : 16;
            const float* xin = lat ? a.in[I_X] + (size_t)m * DM : a.in[I_CTX] + (size_t)(m - TL) * DM;
            float* xout = lat ? a.out + (size_t)m * DM : XC + (size_t)(m - TL) * DM;
            row_update(Y2 + (size_t)m * DM, xin, xout, modp(MOD, 0, r, 2), a.in[I_MIXPOST], XN1 + (size_t)m * DM, a.in[I_MLPPRE], modp(MOD, 0, r, 4), modp(MOD, 0, r, 3), lane);
        }
    }
    grid.sync();

    bf16_t* Hb = (bf16_t*)R2;
    {
        pg8::Gemm g{XN1, W1_t[0], TT, DFF, DM}; pg8::StaticOrder S; S.init(TT, DFF, G, bid);
        pg8::EpiBf16<1, 0> E{Hb, DFF, nullptr};
        pg8::gemm_phase<pg8::EpiBf16<1, 0>, pg8::StaticOrder, true, true>(L3, g, S, E);
    }
    grid.sync();

    float* Y1 = (float*)R1;
    {
        pg8::Gemm g{Hb, W2_t[0], TT, DM, DFF}; pg8::StaticOrder S; S.init(TT, DM, G, bid);
        pg8::EpiF32 E{Y1, DM, nullptr};
        pg8::gemm_phase<pg8::EpiF32, pg8::StaticOrder, true, true>(L3, g, S, E);
    }
    grid.sync();

    bf16_t* XN2 = (bf16_t*)R2;
    {
        for (int m = gw; m < TT; m += NGW) {
            const bool lat = m < TL; const int r = lat ? m / SEQ : 16;
            float* xio = lat ? a.out + (size_t)m * DM : XC + (size_t)(m - TL) * DM;
            row_update(Y1 + (size_t)m * DM, xio, xio, modp(MOD, 0, r, 5), a.in[I_MLPPOST], XN2 + (size_t)m * DM, a.in[I_MIXPRE] + DM, modp(MOD, 1, r, 1), modp(MOD, 1, r, 0), lane);
        }
    }
    grid.sync();

    bf16_t* Qb = (bf16_t*)R1; bf16_t* Kall = (bf16_t*)(R1 + 64 * MiB); bf16_t* Vall = (bf16_t*)(R1 + 82 * MiB);
    {
        { pg8::Gemm g{XN2, Wqkv_t, TL, NQKV, DM}; pg8::StaticOrder S; S.init(TL, NQKV, G, bid);
          pg8::EpiQKV E{Qb, Kall, Vall, 4, SEQ, 0};
          pg8::gemm_phase<pg8::EpiQKV, pg8::StaticOrder, true, true>(L3, g, S, E); }
        { pg8::Gemm g{XN2 + (size_t)TL * DM, Wqkv_t + (size_t)1024 * DM, TC, 512, DM}; pg8::StaticOrder S; S.init(TC, 512, G, bid);
          pg8::EpiQKV E{Qb, Kall, Vall, 0, CTXL, SEQ};
          pg8::gemm_phase<pg8::EpiQKV, pg8::StaticOrder, true, true>(L3, g, S, E); }
    }
    grid.sync();

    {
        const float* qn = a.in[I_QN]; const float* kn = a.in[I_KN];
        for (int m = gw; m < TL; m += NGW) {
            bf16_t* p = Qb + (size_t)m * DM + 16 * lane; const int t = m % SEQ;
            u32x4 w0 = *(const u32x4*)p, w1 = *(const u32x4*)(p + 8);
            float v[16]; const unsigned ww[8] = {w0.x, w0.y, w0.z, w0.w, w1.x, w1.y, w1.z, w1.w};
            float ss = 0.f;
#pragma unroll
            for (int e = 0; e < 8; ++e) { v[2 * e] = bflo(ww[e]); v[2 * e + 1] = bfhi(ww[e]); ss += v[2 * e] * v[2 * e] + v[2 * e + 1] * v[2 * e + 1]; }
            ss += __shfl_xor(ss, 1); ss += __shfl_xor(ss, 2); ss += __shfl_xor(ss, 4);
            const float rstd = 1.0f / sqrtf(ss * (1.f / HD) + EPS);
            const int d0 = (lane & 7) * 16; unsigned ow[8];
#pragma unroll
            for (int e = 0; e < 8; ++e) { const int d = d0 + 2 * e; const float x0 = v[2 * e] * rstd * qn[d], x1 = v[2 * e + 1] * rstd * qn[d + 1];
                const float cs = ROPEC[t * 64 + (d >> 1)], sn = ROPES[t * 64 + (d >> 1)];
                ow[e] = pk2(x0 * cs - x1 * sn, x0 * sn + x1 * cs); }
            *(u32x4*)p = (u32x4){ow[0], ow[1], ow[2], ow[3]}; *(u32x4*)(p + 8) = (u32x4){ow[4], ow[5], ow[6], ow[7]};
        }
        for (int task = gw; task < NB * SKV / 4; task += NGW) {
            const int kr = task * 4 + (lane >> 4); const int s = kr % SKV; const int l16 = lane & 15;
            bf16_t* p = Kall + (size_t)kr * 256 + 16 * l16;
            u32x4 w0 = *(const u32x4*)p, w1 = *(const u32x4*)(p + 8);
            float v[16]; const unsigned ww[8] = {w0.x, w0.y, w0.z, w0.w, w1.x, w1.y, w1.z, w1.w};
            float ss = 0.f;
#pragma unroll
            for (int e = 0; e < 8; ++e) { v[2 * e] = bflo(ww[e]); v[2 * e + 1] = bfhi(ww[e]); ss += v[2 * e] * v[2 * e] + v[2 * e + 1] * v[2 * e + 1]; }
            ss += __shfl_xor(ss, 1); ss += __shfl_xor(ss, 2); ss += __shfl_xor(ss, 4);
            const float rstd = 1.0f / sqrtf(ss * (1.f / HD) + EPS);
            const int d0 = (l16 & 7) * 16; const bool rope = s < SEQ; const int t = rope ? s : 0; unsigned ow[8];
#pragma unroll
            for (int e = 0; e < 8; ++e) { const int d = d0 + 2 * e; const float x0 = v[2 * e] * rstd * kn[d], x1 = v[2 * e + 1] * rstd * kn[d + 1];
                const float cs = rope ? ROPEC[t * 64 + (d >> 1)] : 1.f, sn = rope ? ROPES[t * 64 + (d >> 1)] : 0.f;
                ow[e] = pk2(x0 * cs - x1 * sn, x0 * sn + x1 * cs); }
            *(u32x4*)p = (u32x4){ow[0], ow[1], ow[2], ow[3]}; *(u32x4*)(p + 8) = (u32x4){ow[4], ow[5], ow[6], ow[7]};
        }
    }
    grid.sync();

    bf16_t* Ob = (bf16_t*)R2;
    {
        const int vcu = (G % 8 == 0) ? (bid % 8) * (G / 8) + bid / 8 : bid;
        for (int u = vcu; u < NB * NH * (SEQ / 256); u += G) {
            const int qb = u & 7, h = (u >> 3) & 7, b = u >> 6;
            const attn::bf16* Qp = (const attn::bf16*)(Qb + ((size_t)b * SEQ + qb * 256) * DM + h * HD);
            const attn::bf16* Kp = (const attn::bf16*)(Kall + (size_t)b * SKV * 256 + (h >> 2) * HD);
            const attn::bf16* Vp = (const attn::bf16*)(Vall + (size_t)b * SKV * 256 + (h >> 2) * HD);
            attn::bf16* Op = (attn::bf16*)(Ob + ((size_t)b * SEQ + qb * 256) * DM + h * HD);
            attn::attn_dense_body(Qp, Kp, Vp, Op, SKV, (char*)lds);
            __syncthreads();
        }
    }
    grid.sync();

    float* Y3 = (float*)(R2 + 64 * MiB);
    {
        pg8::Gemm g{Ob, Wo_t, TL, DM, DM}; pg8::StaticOrder S; S.init(TL, DM, G, bid);
        pg8::EpiF32 E{Y3, DM, nullptr};
        pg8::gemm_phase<pg8::EpiF32, pg8::StaticOrder, true, true>(L3, g, S, E);
    }
    grid.sync();

    bf16_t* XN3 = (bf16_t*)R1;
    {
        for (int m = gw; m < TL; m += NGW) { const int r = m / SEQ; float* xio = a.out + (size_t)m * DM;
            row_update(Y3 + (size_t)m * DM, xio, xio, modp(MOD, 1, r, 2), a.in[I_MIXPOST] + DM, XN3 + (size_t)m * DM, a.in[I_MLPPRE] + DM, modp(MOD, 1, r, 4), modp(MOD, 1, r, 3), lane); }
    }
    grid.sync();

    {
        pg8::Gemm g{XN3, W1_t[1], TL, DFF, DM}; pg8::StaticOrder S; S.init(TL, DFF, G, bid);
        pg8::EpiBf16<1, 0> E{Hb, DFF, nullptr};
        pg8::gemm_phase<pg8::EpiBf16<1, 0>, pg8::StaticOrder, true, true>(L3, g, S, E);
    }
    grid.sync();

    {
        pg8::Gemm g{Hb, W2_t[1], TL, DM, DFF}; pg8::StaticOrder S; S.init(TL, DM, G, bid);
        pg8::EpiF32 E{Y1, DM, nullptr};
        pg8::gemm_phase<pg8::EpiF32, pg8::StaticOrder, true, true>(L3, g, S, E);
    }
    grid.sync();

    {
        for (int m = gw; m < TL; m += NGW) { const int r = m / SEQ; float* xio = a.out + (size_t)m * DM;
            row_update(Y1 + (size_t)m * DM, xio, xio, modp(MOD, 1, r, 5), a.in[I_MLPPOST] + DM, nullptr, nullptr, nullptr, nullptr, lane); }
    }
}

extern "C" void kernel_launch(void* const* d_in, const int* in_sizes, int n_in, void* d_out, int out_size, void* d_ws, size_t ws_size, hipStream_t stream) {
    static int grid = 0;
    if (grid == 0) {
        if (n_in != 30 || out_size != TL * DM || ws_size < WS_END) { fprintf(stderr, "kernel_launch: unexpected shapes n_in %d out %d ws %zu\n", n_in, out_size, ws_size); grid = -1; return; }
        int dev = 0, cus = 0, per_cu = 0;
        if (hipGetDevice(&dev) != hipSuccess || hipDeviceGetAttribute(&cus, hipDeviceAttributeMultiprocessorCount, dev) != hipSuccess) { grid = -1; return; }
        if (hipFuncSetAttribute((const void*)fwd_kernel, hipFuncAttributeMaxDynamicSharedMemorySize, LDS_BYTES) != hipSuccess) { grid = -1; return; }
        if (hipOccupancyMaxActiveBlocksPerMultiprocessor(&per_cu, (const void*)fwd_kernel, NTHR, LDS_BYTES) != hipSuccess || per_cu < 1) { fprintf(stderr, "occupancy query failed\n"); grid = -1; return; }
        grid = cus;
    }
    if (grid < 0) return;
    Args a{};
    for (int i = 0; i < 30; ++i) a.in[i] = (const float*)d_in[i];
    a.out = (float*)d_out; a.ws = (unsigned char*)d_ws;
    void* args[] = {&a};
    hipError_t e = hipLaunchCooperativeKernel((const void*)fwd_kernel, dim3(grid), dim3(NTHR), args, LDS_BYTES, stream);
    if (e != hipSuccess) fprintf(stderr, "cooperative launch failed: %s (grid %d)\n", hipGetErrorString(e), grid);
}
```
